# Optimizing an MI355X kernel written in HIP

```python
import math
import jax, jax.numpy as jnp
from jax import lax
import numpy as np

D_MODEL = 1024
BATCH = 8
SEQ = 2048
DEPTH = 2
DEC_BATCH = 128
DEC_SEQ = 4
PAST_LEN = 16384
PAGE_SIZE = 128

N_RET_HEADS = 4
HD_QK = 128
HD_V = 256
D_RET_QK = N_RET_HEADS * HD_QK
D_RET_V = N_RET_HEADS * HD_V
D_CONV = 1024
CONV_W = 3
D_FF = 2816
CHUNK = 128
ROPE_BASE = 10000.0
NORM_EPS = 1e-6
N_NORMS = 6
IN_SIZES = (D_RET_QK, D_RET_QK, D_RET_V, D_RET_V, D_CONV, D_CONV, D_CONV, 2 * D_MODEL)
N_IN = sum(IN_SIZES)

kernel_name = "retention_shortconv_gated_hybrid_step"


def rmsnorm(x, g):
    xf = x.astype(jnp.float32)
    y = xf * lax.rsqrt(jnp.mean(xf * xf, axis=-1, keepdims=True) + NORM_EPS)
    return (y * g.astype(jnp.float32)).astype(x.dtype)


def head_rmsnorm(x):
    xf = x.astype(jnp.float32)
    return (xf * lax.rsqrt(jnp.mean(xf * xf, axis=-1, keepdims=True) + NORM_EPS)).astype(x.dtype)


def swiglu(x, w_up, w_down):
    gate, up = jnp.split(x @ w_up, 2, axis=-1)
    return (jax.nn.silu(gate) * up) @ w_down


def rotary(x, pos):
    d = x.shape[-1]
    half = d // 2
    inv_freq = ROPE_BASE ** (-(jnp.arange(half, dtype=jnp.float32) * 2.0 / d))
    ang = pos.astype(jnp.float32)[:, None] * inv_freq[None, :]
    cos = jnp.cos(ang)[None, :, None, :]
    sin = jnp.sin(ang)[None, :, None, :]
    xf = x.astype(jnp.float32)
    x1, x2 = xf[..., :half], xf[..., half:]
    return jnp.concatenate([x1 * cos - x2 * sin, x2 * cos + x1 * sin], axis=-1).astype(x.dtype)


def log_gammas():
    gam = 1.0 - jnp.exp(jnp.linspace(math.log(1.0 / 32), math.log(1.0 / 512), N_RET_HEADS, dtype=jnp.float32))
    return jnp.log(gam)


def retention(q, k, v, s0):
    B, T, H, _ = q.shape
    C = math.gcd(T, CHUNK)
    n = T // C
    lg = log_gammas()
    idx = jnp.arange(C, dtype=jnp.float32)
    diff = idx[:, None] - idx[None, :]
    dmat = jnp.where(diff[None] >= 0, jnp.exp(jnp.maximum(diff, 0.0)[None] * lg[:, None, None]), 0.0)
    xi = jnp.exp((idx[:, None] + 1.0) * lg[None, :])[None, :, :, None]
    zeta = jnp.exp((C - 1.0 - idx)[:, None] * lg[None, :])[None, :, :, None]
    g_chunk = jnp.exp(C * lg)[None, :, None, None]

    def to_chunks(t):
        return t.astype(jnp.float32).reshape(B, n, C, H, t.shape[-1]).transpose(1, 0, 2, 3, 4)

    def step(s, blk):
        qc, kc, vc = blk
        scores = jnp.einsum('bihd,bjhd->bhij', qc, kc) * dmat[None]
        inner = jnp.einsum('bhij,bjhe->bihe', scores, vc)
        cross = jnp.einsum('bihd,bhde->bihe', qc, s) * xi
        s_new = g_chunk * s + jnp.einsum('bjhd,bjhe->bhde', kc * zeta, vc)
        return s_new, inner + cross

    s_fin, o = lax.scan(step, s0.astype(jnp.float32), (to_chunks(q), to_chunks(k), to_chunks(v)))
    o = o.transpose(1, 0, 2, 3, 4).reshape(B, T, H, HD_V)
    return o.astype(v.dtype), s_fin.astype(s0.dtype)


def short_conv(a, buf, w):
    T = a.shape[1]
    full = jnp.concatenate([buf.astype(a.dtype), a], axis=1)
    z = sum(w[i] * full[:, i:i + T] for i in range(CONV_W))
    return z, full[:, -(CONV_W - 1):]


def mixer(u, pos, s0, buf0, w_in, conv_w, w_ret_out, w_conv_out, w_o):
    B, T, _ = u.shape
    proj = u @ w_in
    cuts = [int(c) for c in np.cumsum(IN_SIZES)[:-1]]
    q, k, v, g, bg, cg, xc, gates = jnp.split(proj, cuts, axis=-1)
    q = rotary(q.reshape(B, T, N_RET_HEADS, HD_QK), pos)
    k = rotary(k.reshape(B, T, N_RET_HEADS, HD_QK), pos) * (HD_QK ** -0.5)
    v = v.reshape(B, T, N_RET_HEADS, HD_V)
    o, s_new = retention(q, k, v, s0)
    o = head_rmsnorm(o).reshape(B, T, D_RET_V)
    o_ret = (jax.nn.silu(g) * o) @ w_ret_out
    z, buf_new = short_conv(cg * xc, buf0, conv_w)
    o_conv = (bg * z) @ w_conv_out
    gate_r, gate_c = jnp.split(jax.nn.sigmoid(gates), 2, axis=-1)
    merged = gate_r * o_ret + gate_c * o_conv
    return merged @ w_o, s_new, buf_new


def layer(x, pos, s0, buf0, norms, w_ffn1_up, w_ffn1_down, w_in, conv_w, w_ret_out, w_conv_out, w_o,
          w_ffn2_up, w_ffn2_down):
    h = x + 0.5 * rmsnorm(swiglu(rmsnorm(x, norms[0]), w_ffn1_up, w_ffn1_down), norms[1])
    m, s_new, buf_new = mixer(rmsnorm(h, norms[2]), pos, s0, buf0, w_in, conv_w, w_ret_out, w_conv_out, w_o)
    h = h + rmsnorm(m, norms[3])
    h = h + 0.5 * rmsnorm(swiglu(rmsnorm(h, norms[4]), w_ffn2_up, w_ffn2_down), norms[5])
    return h, s_new, buf_new


def setup_inputs(seed: int = 0) -> dict:
    key = jax.random.key(seed)
    ks = jax.random.split(key, 16)
    f32 = jnp.float32

    def nrm(k, shape, scale):
        return jax.random.normal(k, shape, f32) * scale

    return {
        "x_prompt": nrm(ks[0], (BATCH, SEQ, D_MODEL), 1.0),
        "x_sample": nrm(ks[1], (DEC_BATCH, DEC_SEQ, D_MODEL), 1.0),
        "state_ret": nrm(ks[2], (DEPTH, DEC_BATCH, N_RET_HEADS, HD_QK, HD_V), 1.0),
        "state_conv": nrm(ks[3], (DEPTH, DEC_BATCH, CONV_W - 1, D_CONV), 0.5),
        "norms": 1.0 + nrm(ks[4], (DEPTH, N_NORMS, D_MODEL), 0.05),
        "w_ffn1_up": nrm(ks[5], (DEPTH, D_MODEL, 2 * D_FF), D_MODEL ** -0.5),
        "w_ffn1_down": nrm(ks[6], (DEPTH, D_FF, D_MODEL), D_FF ** -0.5),
        "w_in": nrm(ks[7], (DEPTH, D_MODEL, N_IN), D_MODEL ** -0.5),
        "conv_w": nrm(ks[8], (DEPTH, CONV_W, D_CONV), CONV_W ** -0.5),
        "w_ret_out": nrm(ks[9], (DEPTH, D_RET_V, D_MODEL), D_RET_V ** -0.5),
        "w_conv_out": nrm(ks[10], (DEPTH, D_CONV, D_MODEL), D_CONV ** -0.5),
        "w_o": nrm(ks[11], (DEPTH, D_MODEL, D_MODEL), D_MODEL ** -0.5),
        "w_ffn2_up": nrm(ks[12], (DEPTH, D_MODEL, 2 * D_FF), D_MODEL ** -0.5),
        "w_ffn2_down": nrm(ks[13], (DEPTH, D_FF, D_MODEL), D_FF ** -0.5),
    }


def reference(x_prompt, x_sample, state_ret, state_conv, norms, w_ffn1_up, w_ffn1_down, w_in, conv_w,
              w_ret_out, w_conv_out, w_o, w_ffn2_up, w_ffn2_down):
    pos_p = jnp.arange(SEQ, dtype=jnp.int32)
    pos_s = PAST_LEN + jnp.arange(DEC_SEQ, dtype=jnp.int32)
    yp, ys = x_prompt, x_sample
    sp_list, bp_list, ss_list, bs_list = [], [], [], []
    for l in range(DEPTH):
        params = (norms[l], w_ffn1_up[l], w_ffn1_down[l], w_in[l], conv_w[l], w_ret_out[l], w_conv_out[l],
                  w_o[l], w_ffn2_up[l], w_ffn2_down[l])
        s0_p = jnp.zeros((BATCH, N_RET_HEADS, HD_QK, HD_V), x_prompt.dtype)
        b0_p = jnp.zeros((BATCH, CONV_W - 1, D_CONV), x_prompt.dtype)
        yp, sp, bp = layer(yp, pos_p, s0_p, b0_p, *params)
        ys, ss, bs = layer(ys, pos_s, state_ret[l], state_conv[l], *params)
        sp_list.append(sp); bp_list.append(bp); ss_list.append(ss); bs_list.append(bs)
    ret_state_prompt = jnp.stack(sp_list)
    conv_state_prompt = jnp.stack(bp_list)
    ret_state_sample = jnp.stack(ss_list)
    conv_state_sample = jnp.stack(bs_list)
    return (yp, ys, ret_state_prompt, conv_state_prompt, ret_state_sample, conv_state_sample)
```

```cpp
#include <hip/hip_runtime.h>
#include <cstdio>
#include <cstdint>
#include <cmath>

#ifndef MK_PER_PHASE
#define MK_PER_PHASE 0
#endif

namespace pg8 {
#define PG8_LAS __attribute__((address_space(3)))
typedef unsigned short bf16_t;
typedef short bf16x8 __attribute__((ext_vector_type(8)));
typedef float f32x4 __attribute__((ext_vector_type(4)));
typedef unsigned u32x4 __attribute__((ext_vector_type(4)));
constexpr int BM = 256, BK = 64, HALF = 128, HTB = HALF * BK * 2  , STAGE_BYTES = 8 * HTB, NXCD = 8, WGM = 8;

__host__ __device__ __forceinline__ int lds_byte(int r, int c) { const int st = (r >> 4) * 2 + (c >> 5), rr = r & 15, cc = c & 31, ob = rr * 64 + cc * 2; return st * 1024 + (ob ^ (((ob >> 9) & 1) << 5)); }
__host__ __device__ __forceinline__ void stage_rc(int b, int& R, int& C) { const int st = b / 1024, sb = b % 1024, swz = sb ^ (((sb >> 9) & 1) << 5); R = (st >> 1) * 16 + swz / 64; C = (st & 1) * 32 + (swz % 64) / 2; }
__host__ __device__ __forceinline__ int perm32(int rho) { const int n = rho >> 4, i = rho & 15; return 8 * (i >> 2) + 4 * n + (i & 3); }

struct Unit { int pm, pn; };
struct Gemm { const bf16_t* A; const bf16_t* Bt; int M, N, K; };

struct StaticOrder {
    int nM, nN, nwg, G, c;
    __host__ __device__ void init(int M, int N, int G_, int c_) { nM = M / BM; nN = N / BM; nwg = nM * nN; G = G_; c = c_; }
    __host__ __device__ bool next(int i, Unit& u) const {
        const long L = (long)i * G + c; if (L >= nwg) return false;
        int wgid = (int)L; { const int q = nwg / NXCD, r = nwg % NXCD, xcd = wgid % NXCD, off = wgid / NXCD; wgid = (xcd < r ? xcd * (q + 1) : r * (q + 1) + (xcd - r) * q) + off; }
        const int nig = WGM * nN, gid = wgid / nig, fm = gid * WGM, gsz = (nM - fm) < WGM ? (nM - fm) : WGM;
        u.pm = fm + ((wgid % nig) % gsz); u.pn = (wgid % nig) / gsz; return true;
    }
};

__device__ __forceinline__ unsigned cvt_pk_bf16(float lo, float hi) { unsigned r; asm volatile("v_cvt_pk_bf16_f32 %0, %1, %2" : "=v"(r) : "v"(lo), "v"(hi)); return r; }
__device__ __forceinline__ float bf_lo(unsigned w) { return __uint_as_float(w << 16); }
__device__ __forceinline__ float bf_hi(unsigned w) { return __uint_as_float(w & 0xffff0000u); }
__device__ __forceinline__ float fsigmoid(float x) { return __builtin_amdgcn_rcpf(1.0f + __expf(-x)); }
__device__ __forceinline__ float fsilu(float x) { return x * fsigmoid(x); }


struct EpiF32 {
    static constexpr bool PERM = false, HAS_MID = false; static constexpr int MID_T = 0;
    float* C; int ldc;
    __device__ __forceinline__ void mid(f32x4 (&)[2][2][4][2], const Unit&, int, int, int, int) const {}
    __device__ __forceinline__ void operator()(const f32x4 (&acc)[2][2][4][2], const Unit& u, int wr, int wc, int fr, int fq) const {
        asm volatile("" : "+v"(fr), "+v"(fq));
        const int row0 = u.pm * BM + wr * 64 + fr, col0 = u.pn * BM + wc * 32 + 4 * fq;
#pragma unroll
        for (int ai = 0; ai < 2; ++ai)
#pragma unroll
            for (int m = 0; m < 4; ++m) { float* rowp = C + (size_t)(row0 + ai * HALF + m * 16) * ldc + col0;
#pragma unroll
                for (int bj = 0; bj < 2; ++bj)
#pragma unroll
                    for (int n = 0; n < 2; ++n) *(f32x4*)(rowp + bj * HALF + n * 16) = acc[ai][bj][m][n]; }
    }
};

struct EpiSwiGLU {
    static constexpr bool PERM = true, HAS_MID = false; static constexpr int MID_T = 0;
    bf16_t* O; int ldo;
    __device__ __forceinline__ void mid(f32x4 (&)[2][2][4][2], const Unit&, int, int, int, int) const {}
    __device__ __forceinline__ void operator()(const f32x4 (&acc)[2][2][4][2], const Unit& u, int wr, int wc, int fr, int fq) const {
        asm volatile("" : "+v"(fr), "+v"(fq));
        const int row0 = u.pm * BM + wr * 64 + fr, col0 = u.pn * HALF + wc * 32 + 8 * fq;
#pragma unroll
        for (int ai = 0; ai < 2; ++ai)
#pragma unroll
            for (int m = 0; m < 4; ++m) { bf16_t* rowp = O + (size_t)(row0 + ai * HALF + m * 16) * ldo + col0;
                const f32x4 g0 = acc[ai][0][m][0], g1 = acc[ai][0][m][1], u0 = acc[ai][1][m][0], u1 = acc[ai][1][m][1];
                f32x4 v0, v1;
#pragma unroll
                for (int j = 0; j < 4; ++j) { v0[j] = fsilu(g0[j]) * u0[j]; v1[j] = fsilu(g1[j]) * u1[j]; }
                u32x4 w; w.x = cvt_pk_bf16(v0[0], v0[1]); w.y = cvt_pk_bf16(v0[2], v0[3]); w.z = cvt_pk_bf16(v1[0], v1[1]); w.w = cvt_pk_bf16(v1[2], v1[3]);
                *(u32x4*)rowp = w; }
    }
};

struct EpiMerged {
    static constexpr bool PERM = true, HAS_MID = true; static constexpr int MID_T = 16;
    const bf16_t* GR; const bf16_t* GC; bf16_t* O;
    __device__ __forceinline__ void mid(f32x4 (&acc)[2][2][4][2], const Unit& u, int wr, int wc, int fr, int fq) const {
        asm volatile("" : "+v"(fr), "+v"(fq));
        const int row0 = u.pm * BM + wr * 64 + fr, col0 = u.pn * BM + wc * 32 + 8 * fq;
#pragma unroll
        for (int ai = 0; ai < 2; ++ai)
#pragma unroll
            for (int m = 0; m < 4; ++m) { const size_t off = (size_t)(row0 + ai * HALF + m * 16) * 1024 + col0;
#pragma unroll
                for (int bj = 0; bj < 2; ++bj) {
                    const u32x4 r4 = *(const u32x4*)(GR + off + bj * HALF), c4 = *(const u32x4*)(GC + off + bj * HALF);
                    f32x4 q0, q1;
                    q0[0] = bf_lo(r4.x) * __builtin_amdgcn_rcpf(bf_lo(c4.x)); q0[1] = bf_hi(r4.x) * __builtin_amdgcn_rcpf(bf_hi(c4.x));
                    q0[2] = bf_lo(r4.y) * __builtin_amdgcn_rcpf(bf_lo(c4.y)); q0[3] = bf_hi(r4.y) * __builtin_amdgcn_rcpf(bf_hi(c4.y));
                    q1[0] = bf_lo(r4.z) * __builtin_amdgcn_rcpf(bf_lo(c4.z)); q1[1] = bf_hi(r4.z) * __builtin_amdgcn_rcpf(bf_hi(c4.z));
                    q1[2] = bf_lo(r4.w) * __builtin_amdgcn_rcpf(bf_lo(c4.w)); q1[3] = bf_hi(r4.w) * __builtin_amdgcn_rcpf(bf_hi(c4.w));
                    acc[ai][bj][m][0] = acc[ai][bj][m][0] * q0; acc[ai][bj][m][1] = acc[ai][bj][m][1] * q1; }
                asm volatile("" ::: "memory"); }
    }
    __device__ __forceinline__ void operator()(const f32x4 (&acc)[2][2][4][2], const Unit& u, int wr, int wc, int fr, int fq) const {
        asm volatile("" : "+v"(fr), "+v"(fq));
        const int row0 = u.pm * BM + wr * 64 + fr, col0 = u.pn * BM + wc * 32 + 8 * fq;
#pragma unroll
        for (int ai = 0; ai < 2; ++ai)
#pragma unroll
            for (int m = 0; m < 4; ++m) { const size_t off = (size_t)(row0 + ai * HALF + m * 16) * 1024 + col0;
#pragma unroll
                for (int bj = 0; bj < 2; ++bj) {
                    const u32x4 c4 = *(const u32x4*)(GC + off + bj * HALF);
                    const f32x4 a0 = acc[ai][bj][m][0], a1 = acc[ai][bj][m][1];
                    u32x4 w; w.x = cvt_pk_bf16(a0[0] * bf_lo(c4.x), a0[1] * bf_hi(c4.x)); w.y = cvt_pk_bf16(a0[2] * bf_lo(c4.y), a0[3] * bf_hi(c4.y));
                    w.z = cvt_pk_bf16(a1[0] * bf_lo(c4.z), a1[1] * bf_hi(c4.z)); w.w = cvt_pk_bf16(a1[2] * bf_lo(c4.w), a1[3] * bf_hi(c4.w));
                    *(u32x4*)(O + off + bj * HALF) = w; }
                asm volatile("" ::: "memory"); }
    }
};

struct EpiInProj {
    static constexpr bool PERM = true, HAS_MID = false; static constexpr int MID_T = 0;
    bf16_t *Q, *Kb;
    bf16_t *PB;
    bf16_t *Ab;
    const float *COS, *SIN;
    float *csp, *css;
    size_t pbstride;
    __device__ __forceinline__ void mid(f32x4 (&)[2][2][4][2], const Unit&, int, int, int, int) const {}
    __device__ __forceinline__ void operator()(const f32x4 (&acc)[2][2][4][2], const Unit& u, int wr, int wc, int fr, int fq) const {
        asm volatile("" : "+v"(fr), "+v"(fq));
        const int row0 = u.pm * BM + wr * 64 + fr, c127 = wc * 32 + 8 * fq; const int pn = u.pn;
        if (pn < 4) {
            bf16_t* dst = (pn < 2) ? Q : Kb; const float sc = (pn < 2) ? 1.0f : 0.08838834764831845f;
            const int head = 2 * (pn & 1) + (wc >> 1), d0 = (wc & 1) * 32 + 8 * fq;
#pragma unroll
            for (int ai = 0; ai < 2; ++ai)
#pragma unroll
                for (int m = 0; m < 4; ++m) { const int row = row0 + ai * HALF + m * 16;
                    const int tpos = (row < 16384) ? (row & 2047) : (2048 + (row & 3));
                    const f32x4 c0 = *(const f32x4*)(COS + tpos * 64 + d0), c1 = *(const f32x4*)(COS + tpos * 64 + d0 + 4);
                    const f32x4 s0 = *(const f32x4*)(SIN + tpos * 64 + d0), s1 = *(const f32x4*)(SIN + tpos * 64 + d0 + 4);
                    const f32x4 x10 = acc[ai][0][m][0], x11 = acc[ai][0][m][1], x20 = acc[ai][1][m][0], x21 = acc[ai][1][m][1];
                    const f32x4 o10 = (x10 * c0 - x20 * s0) * sc, o11 = (x11 * c1 - x21 * s1) * sc;
                    const f32x4 o20 = (x20 * c0 + x10 * s0) * sc, o21 = (x21 * c1 + x11 * s1) * sc;
                    u32x4 w1, w2; w1.x = cvt_pk_bf16(o10[0], o10[1]); w1.y = cvt_pk_bf16(o10[2], o10[3]); w1.z = cvt_pk_bf16(o11[0], o11[1]); w1.w = cvt_pk_bf16(o11[2], o11[3]);
                    w2.x = cvt_pk_bf16(o20[0], o20[1]); w2.y = cvt_pk_bf16(o20[2], o20[3]); w2.z = cvt_pk_bf16(o21[0], o21[1]); w2.w = cvt_pk_bf16(o21[2], o21[3]);
                    bf16_t* p = dst + (size_t)row * 512 + head * 128 + d0;
                    *(u32x4*)p = w1; *(u32x4*)(p + 64) = w2;
                    asm volatile("" ::: "memory"); }
        } else if (pn >= 16 && pn < 24) {
            const int col = (pn - 16) * 128 + c127;
#pragma unroll
            for (int ai = 0; ai < 2; ++ai)
#pragma unroll
                for (int m = 0; m < 4; ++m) { const int row = row0 + ai * HALF + m * 16;
                    const f32x4 a0 = acc[ai][0][m][0] * acc[ai][1][m][0], a1 = acc[ai][0][m][1] * acc[ai][1][m][1];
                    u32x4 w; w.x = cvt_pk_bf16(a0[0], a0[1]); w.y = cvt_pk_bf16(a0[2], a0[3]); w.z = cvt_pk_bf16(a1[0], a1[1]); w.w = cvt_pk_bf16(a1[2], a1[3]);
                    *(u32x4*)(Ab + (size_t)row * 1024 + col) = w;
                    float* sp = nullptr;
                    if (row < 16384) { const int t = row & 2047; if (t >= 2046) sp = csp + ((size_t)(row >> 11) * 2 + (t - 2046)) * 1024 + col; }
                    else { const int t = row & 3; if (t >= 2) sp = css + ((size_t)((row - 16384) >> 2) * 2 + (t - 2)) * 1024 + col; }
                    if (sp) { *(f32x4*)sp = a0; *(f32x4*)(sp + 4) = a1; } }
        } else {
            const int idx = (pn < 16) ? ((pn - 4) >> 2) : (3 + ((pn - 24) >> 2));
            const int colt = ((pn < 16) ? ((pn - 4) & 3) : ((pn - 24) & 3)) * 256 + c127;
            bf16_t* dst = PB + (size_t)idx * pbstride;
            const int mode = (idx == 1) ? 1 : (idx >= 3 ? 2 : 0);
#pragma unroll
            for (int ai = 0; ai < 2; ++ai)
#pragma unroll
                for (int m = 0; m < 4; ++m) { bf16_t* rowp = dst + (size_t)(row0 + ai * HALF + m * 16) * 1024 + colt;
#pragma unroll
                    for (int bj = 0; bj < 2; ++bj) { f32x4 v0 = acc[ai][bj][m][0], v1 = acc[ai][bj][m][1];
                        if (mode == 1) {
#pragma unroll
                            for (int j = 0; j < 4; ++j) { v0[j] = fsilu(v0[j]); v1[j] = fsilu(v1[j]); } }
                        else if (mode == 2) {
#pragma unroll
                            for (int j = 0; j < 4; ++j) { v0[j] = fsigmoid(v0[j]); v1[j] = fsigmoid(v1[j]); } }
                        u32x4 w; w.x = cvt_pk_bf16(v0[0], v0[1]); w.y = cvt_pk_bf16(v0[2], v0[3]); w.z = cvt_pk_bf16(v1[0], v1[1]); w.w = cvt_pk_bf16(v1[2], v1[3]);
                        *(u32x4*)(rowp + bj * HALF) = w; } }
        }
    }
};

template <class Epi, class Sched, bool ALIGN_EPI = false, bool SP2 = false>
__device__ __forceinline__ void gemm_phase(PG8_LAS unsigned char* lds, const Gemm g, const Sched& S, const Epi& E) {
    int tid_ = threadIdx.x; asm volatile("" : "+v"(tid_));
    const int tid = tid_, wid = __builtin_amdgcn_readfirstlane(tid >> 6), lane = tid & 63, wr = wid >> 2, wc = wid & 3, fr = lane & 15, fq = lane >> 4;
    const int K = g.K, nt = K / BK;
    unsigned voffA[2], voffB[2];
#pragma unroll
    for (int i = 0; i < 2; ++i) { int R, C; stage_rc(tid * 16 + i * 8192, R, C); const int Rb = Epi::PERM ? ((R & ~31) + perm32(R & 31)) : R;
        voffA[i] = (unsigned)(R * K + C) * 2u; voffB[i] = (unsigned)(Rb * K + C) * 2u; }
    const size_t kstep = (size_t)(BK * 2);
    const size_t hstep = (size_t)HALF * K * 2;
    const size_t tstep = 2 * hstep;
    const unsigned ldsw = (unsigned)wid * 1024u;
    const int aoff = lds_byte(wr * 64 + fr, fq * 8), boff = lds_byte(wc * 32 + fr, fq * 8);
#define PG8_SA(b, h) (((b) * 2 + (h)) * HTB)
#define PG8_SB(b, h) ((4 + (b) * 2 + (h)) * HTB)
#define PG8_STAGE(bufoff, gbase, voff) do { _Pragma("unroll") for (int _i = 0; _i < 2; ++_i) \
        __builtin_amdgcn_global_load_lds((const unsigned*)((const char*)(gbase) + (voff)[_i]), (PG8_LAS unsigned*)(lds + (bufoff) + ldsw + _i * 8192), 16, 0, 0); } while (0)
#define PG8_LDA(dst, b, h) do { _Pragma("unroll") for (int m = 0; m < 4; ++m) _Pragma("unroll") for (int k = 0; k < 2; ++k) dst[m][k] = *(const PG8_LAS bf16x8*)(lds + PG8_SA(b, h) + aoff + m * 2048 + k * 1024); } while (0)
#define PG8_LDB(dst, b, h) do { _Pragma("unroll") for (int n = 0; n < 2; ++n) _Pragma("unroll") for (int k = 0; k < 2; ++k) dst[n][k] = *(const PG8_LAS bf16x8*)(lds + PG8_SB(b, h) + boff + n * 2048 + k * 1024); } while (0)
#define PG8_MMA(ai, bj, At, Bt) do { __builtin_amdgcn_s_setprio(1); _Pragma("unroll") for (int m = 0; m < 4; ++m) _Pragma("unroll") for (int n = 0; n < 2; ++n) _Pragma("unroll") for (int k = 0; k < 2; ++k) \
        acc[ai][bj][m][n] = __builtin_amdgcn_mfma_f32_16x16x32_bf16(Bt[n][k], At[m][k], acc[ai][bj][m][n], 0, 0, 0); __builtin_amdgcn_s_setprio(0); } while (0)
#define PG8_WAIT_V(n) asm volatile("s_waitcnt vmcnt(" #n ")" ::: "memory")
#define PG8_WAIT_L(n) asm volatile("s_waitcnt lgkmcnt(" #n ")" ::: "memory")
#define PG8_BAR __builtin_amdgcn_s_barrier()
#define PG8_SCHED __builtin_amdgcn_sched_barrier(0)
    Unit cur, nxt; int ui = 0;
    if (!S.next(0, cur)) return;
    f32x4 acc[2][2][4][2];
#pragma unroll
    for (int a = 0; a < 2; ++a)
#pragma unroll
        for (int b = 0; b < 2; ++b)
#pragma unroll
            for (int m = 0; m < 4; ++m)
#pragma unroll
                for (int n = 0; n < 2; ++n) acc[a][b][m][n] = (f32x4){0.f, 0.f, 0.f, 0.f};
    bf16x8 At[4][2], B0[2][2], B1[2][2];
    const char* cA = (const char*)g.A + (size_t)cur.pm * tstep; const char* cB = (const char*)g.Bt + (size_t)cur.pn * tstep;
    if constexpr (SP2) {
        PG8_STAGE(PG8_SB(0, 0), cB, voffB); PG8_STAGE(PG8_SB(0, 1), cB + hstep, voffB); PG8_STAGE(PG8_SA(0, 0), cA, voffA); PG8_STAGE(PG8_SA(0, 1), cA + hstep, voffA);
        if (wr == 1) PG8_BAR;
        PG8_WAIT_V(2); PG8_BAR;
        PG8_STAGE(PG8_SB(1, 0), cB + kstep, voffB); PG8_STAGE(PG8_SA(1, 0), cA + kstep, voffA); PG8_STAGE(PG8_SB(1, 1), cB + hstep + kstep, voffB);
        PG8_WAIT_V(6); PG8_BAR;
    } else {
        PG8_STAGE(PG8_SB(0, 0), cB, voffB); PG8_STAGE(PG8_SA(0, 0), cA, voffA); PG8_STAGE(PG8_SB(0, 1), cB + hstep, voffB); PG8_STAGE(PG8_SA(0, 1), cA + hstep, voffA);
        if (wr == 1) PG8_BAR;
        PG8_WAIT_V(4); PG8_BAR;
        PG8_STAGE(PG8_SB(1, 0), cB + kstep, voffB); PG8_STAGE(PG8_SA(1, 0), cA + kstep, voffA); PG8_STAGE(PG8_SB(1, 1), cB + hstep + kstep, voffB);
        PG8_WAIT_V(6); PG8_BAR;
    }
    for (;;) {
        const bool has_next = S.next(ui + 1, nxt);
        const char* nA = has_next ? (const char*)g.A + (size_t)nxt.pm * tstep : cA; const char* nB = has_next ? (const char*)g.Bt + (size_t)nxt.pn * tstep : cB;
        for (int t = 0; t < nt; t += 2) {
            const bool last = (t == nt - 2);
            const char* a1 = cA + (size_t)(t + 1) * kstep;
            const char* a2 = last ? nA : cA + (size_t)(t + 2) * kstep; const char* b2 = last ? nB : cB + (size_t)(t + 2) * kstep;
            const char* a3 = a2 + kstep; const char* b3 = b2 + kstep;
            if constexpr (Epi::HAS_MID) { if (t == Epi::MID_T) E.mid(acc, cur, wr, wc, fr, fq); }
            if constexpr (SP2) {
            PG8_LDB(B0, 0, 0); PG8_LDB(B1, 0, 1); PG8_SCHED; PG8_LDA(At, 0, 0); PG8_STAGE(PG8_SA(1, 1), a1 + hstep, voffA);
            PG8_WAIT_V(8); PG8_WAIT_L(0); PG8_BAR; PG8_MMA(0, 0, At, B0); PG8_MMA(0, 1, At, B1); PG8_BAR; PG8_SCHED;
            PG8_LDA(At, 0, 1); PG8_STAGE(PG8_SB(0, 0), b2, voffB); PG8_STAGE(PG8_SB(0, 1), b2 + hstep, voffB); PG8_STAGE(PG8_SA(0, 0), a2, voffA);
            PG8_WAIT_V(8); PG8_WAIT_L(0); PG8_BAR; PG8_MMA(1, 0, At, B0); PG8_MMA(1, 1, At, B1); PG8_BAR; PG8_SCHED;
            PG8_LDB(B0, 1, 0); PG8_LDB(B1, 1, 1); PG8_SCHED; PG8_LDA(At, 1, 0); PG8_STAGE(PG8_SA(0, 1), a2 + hstep, voffA);
            PG8_WAIT_V(8); PG8_WAIT_L(0); PG8_BAR; PG8_MMA(0, 0, At, B0); PG8_MMA(0, 1, At, B1); PG8_BAR; PG8_SCHED;
            PG8_LDA(At, 1, 1); PG8_STAGE(PG8_SB(1, 0), b3, voffB); PG8_STAGE(PG8_SB(1, 1), b3 + hstep, voffB); PG8_STAGE(PG8_SA(1, 0), a3, voffA);
            PG8_WAIT_V(8); PG8_WAIT_L(0); PG8_BAR; PG8_MMA(1, 0, At, B0); PG8_MMA(1, 1, At, B1); PG8_BAR; PG8_SCHED;
            } else {
            PG8_LDB(B0, 0, 0); PG8_SCHED; PG8_LDA(At, 0, 0); PG8_STAGE(PG8_SA(1, 1), a1 + hstep, voffA);
            PG8_WAIT_L(8); PG8_BAR; PG8_WAIT_L(0); PG8_MMA(0, 0, At, B0); PG8_BAR; PG8_SCHED;
            PG8_LDB(B1, 0, 1); PG8_STAGE(PG8_SB(0, 0), b2, voffB);
            PG8_BAR; PG8_WAIT_L(0); PG8_MMA(0, 1, At, B1); PG8_BAR;
            PG8_LDA(At, 0, 1); PG8_STAGE(PG8_SA(0, 0), a2, voffA);
            PG8_BAR; PG8_WAIT_L(0); PG8_MMA(1, 0, At, B0); PG8_BAR; PG8_SCHED;
            PG8_STAGE(PG8_SB(0, 1), b2 + hstep, voffB);
            PG8_WAIT_V(6); PG8_BAR; PG8_MMA(1, 1, At, B1); PG8_BAR;
            PG8_LDB(B0, 1, 0); PG8_SCHED; PG8_LDA(At, 1, 0); PG8_STAGE(PG8_SA(0, 1), a2 + hstep, voffA);
            PG8_WAIT_L(8); PG8_BAR; PG8_WAIT_L(0); PG8_MMA(0, 0, At, B0); PG8_BAR; PG8_SCHED;
            PG8_LDB(B1, 1, 1); PG8_STAGE(PG8_SB(1, 0), b3, voffB);
            PG8_BAR; PG8_WAIT_L(0); PG8_MMA(0, 1, At, B1); PG8_BAR;
            PG8_LDA(At, 1, 1); PG8_STAGE(PG8_SA(1, 0), a3, voffA);
            PG8_BAR; PG8_WAIT_L(0); PG8_MMA(1, 0, At, B0); PG8_BAR; PG8_SCHED;
            PG8_STAGE(PG8_SB(1, 1), b3 + hstep, voffB);
            PG8_WAIT_V(6); PG8_BAR; PG8_MMA(1, 1, At, B1); PG8_BAR;
            }
        }
        if constexpr (ALIGN_EPI) { if (wr == 0) PG8_BAR; }
        E(acc, cur, wr, wc, fr, fq);
        if (!has_next) break;
#pragma unroll
        for (int a = 0; a < 2; ++a)
#pragma unroll
            for (int b = 0; b < 2; ++b)
#pragma unroll
                for (int m = 0; m < 4; ++m)
#pragma unroll
                    for (int n = 0; n < 2; ++n) acc[a][b][m][n] = (f32x4){0.f, 0.f, 0.f, 0.f};
        cur = nxt; cA = nA; cB = nB; ++ui;
        if constexpr (ALIGN_EPI) { if (wr == 1) PG8_BAR; }
    }
    PG8_WAIT_V(0);
    if constexpr (!ALIGN_EPI) { if (wr == 0) PG8_BAR; }
    PG8_BAR;
#undef PG8_SA
#undef PG8_SB
#undef PG8_STAGE
#undef PG8_LDA
#undef PG8_LDB
#undef PG8_MMA
#undef PG8_WAIT_V
#undef PG8_WAIT_L
#undef PG8_BAR
#undef PG8_SCHED
}
}

constexpr int NWAVES = 8;
constexpr int D = 1024, TP = 16384, TS = 512, T = TP + TS;
constexpr int SEQ = 2048, DEPTH = 2, NH = 4, HQK = 128, HV = 256, DFF = 2816, NIN = 8192;
constexpr float EPS = 1e-6f;
constexpr size_t OUT_Y = 0, OUT_RSP = 17301504, OUT_CSP = 19398656, OUT_RSS = 19431424, OUT_CSS = 52985856;

constexpr size_t MiB = 1u << 20;
constexpr size_t WS_CTL = 0, CTL_ZERO_BYTES = 1 * MiB;
constexpr size_t WS_TAB = 1 * MiB;
constexpr size_t TAB_HALF = 2052 * 64 * 4;
constexpr size_t WS_SS = 3 * MiB;
constexpr size_t WS_W = 6 * MiB;
constexpr size_t W_1U = 0, W_1D = W_1U + (size_t)2 * DFF * D * 2, W_IN = W_1D + (size_t)D * DFF * 2, W_RC = W_IN + (size_t)NIN * D * 2,
                 W_O = W_RC + (size_t)D * 2 * D * 2, W_2U = W_O + (size_t)D * D * 2, W_2D = W_2U + (size_t)2 * DFF * D * 2, W_LAYER = W_2D + (size_t)D * DFF * 2;
static_assert(W_LAYER == 55 * MiB, "weights per layer");
constexpr size_t WS_XN = 116 * MiB;
constexpr size_t WS_F = 149 * MiB;
constexpr size_t WS_R1 = 215 * MiB;
constexpr size_t R1_Q = 0, R1_K = (size_t)T * 512 * 2, R1_PB = 2 * R1_K, PB_STRIDE_B = (size_t)T * 1024 * 2, R1_A = R1_PB + 5 * PB_STRIDE_B, R1_END = R1_A + PB_STRIDE_B;
constexpr size_t WS_END = WS_R1 + R1_END;
static_assert(WS_END <= 448 * MiB, "workspace map");
static_assert((size_t)T * DFF * 2 <= R1_END, "ACT overlay");

constexpr int CW_BAR = 4096;

constexpr int RING_OFF = 0, RING_BYTES = 131072;
constexpr int LDSCTL_OFF = RING_BYTES, MISC_OFF = LDSCTL_OFF + 320;
constexpr int LDS_BYTES = 147456;

#define GAS __attribute__((address_space(1)))
#define LAS __attribute__((address_space(3)))
typedef unsigned short bf16;
typedef unsigned v4u __attribute__((ext_vector_type(4)));
typedef unsigned v2u __attribute__((ext_vector_type(2)));
typedef float f32x4 __attribute__((ext_vector_type(4)));
typedef short bf16x8 __attribute__((ext_vector_type(8)));
__device__ __forceinline__ unsigned f2bf(float f) { unsigned u = __builtin_bit_cast(unsigned, f); return (u + 0x7fffu + ((u >> 16) & 1u)) >> 16; }
__device__ __forceinline__ unsigned pk2(float lo, float hi) { return f2bf(lo) | (f2bf(hi) << 16); }
__device__ __forceinline__ float bflo(unsigned w) { return __uint_as_float(w << 16); }
__device__ __forceinline__ float bfhi(unsigned w) { return __uint_as_float(w & 0xffff0000u); }
__device__ __forceinline__ float bf2f(unsigned short h) { return __uint_as_float(((unsigned)h) << 16); }

#define XB_TMO      128
#define XB_XCNT(j)  (256  + 64 * (j))
#define XB_XSUB(j)  (1280 + 64 * (j))
#define XB_XGEN(j)  (2304 + 64 * (j))
#define XB_TOP      3328
#define XB_TOPGEN   3392
#define XCD_BAR_WORDS 3456
#define XB_SPIN_CAP (1u << 22)

__device__ __forceinline__ unsigned xb_ld(unsigned* p)              { return __hip_atomic_load(p, __ATOMIC_RELAXED, __HIP_MEMORY_SCOPE_AGENT); }
__device__ __forceinline__ unsigned xb_add(unsigned* p, unsigned v) { return __hip_atomic_fetch_add(p, v, __ATOMIC_RELAXED, __HIP_MEMORY_SCOPE_AGENT); }
__device__ __forceinline__ unsigned xb_xcc_id() { return (unsigned)__builtin_amdgcn_s_getreg((3 << 11) | 20) & 0xFu; }
#define XB_SPIN(cond, bar) do { unsigned _sp = 0; while (cond) { __builtin_amdgcn_s_sleep(1); \
    if ((++_sp & 255u) == 0u) { if (xb_ld(&(bar)[XB_TMO])) break; if (_sp > XB_SPIN_CAP) { atomicAdd(&(bar)[XB_TMO], 1u); break; } } } } while (0)

struct XcdBarrier { unsigned* bar; unsigned x; volatile LAS unsigned* st; };

__device__ __forceinline__ XcdBarrier xcd_barrier_post(unsigned* bar, volatile LAS unsigned* st) {
    XcdBarrier b; b.bar = bar; b.x = xb_xcc_id(); b.st = st;
    if (threadIdx.x == 0) (void)xb_add(&bar[XB_XCNT(b.x)], 1u);
    return b;
}
__device__ __forceinline__ void xcd_barrier_complete(unsigned* bar, unsigned x, unsigned& nloc, unsigned& nx) {
    const unsigned G = gridDim.x * gridDim.y * gridDim.z;
    unsigned sum, cnt, mine, sp = 0u;
    for (;;) {
        sum = 0u; cnt = 0u; mine = 0u;
#pragma unroll
        for (unsigned j = 0; j < 16; ++j) { const unsigned c = xb_ld(&bar[XB_XCNT(j)]); sum += c; cnt += (c > 0u) ? 1u : 0u; mine = (j == x) ? c : mine; }
        if (sum == G) break;
        __builtin_amdgcn_s_sleep(1);
        if ((++sp & 255u) == 0u) { if (xb_ld(&bar[XB_TMO])) break; if (sp > XB_SPIN_CAP) { atomicAdd(&bar[XB_TMO], 1u); break; } }
    }
    nloc = mine > 0u ? mine : 1u; nx = cnt > 0u ? cnt : 1u;
}
__device__ __forceinline__ void xcd_barrier(const XcdBarrier& b) {
    asm volatile("s_waitcnt vmcnt(0)" ::: "memory");
    __syncthreads();
    if (threadIdx.x == 0) {
        unsigned* bar = b.bar;
        __builtin_amdgcn_s_waitcnt(0);
        unsigned nloc = b.st[0], nx = b.st[1];
        if (nloc == 0u) { xcd_barrier_complete(bar, b.x, nloc, nx); b.st[0] = nloc; b.st[1] = nx; }
        const unsigned old = xb_add(&bar[XB_XSUB(b.x)], 1u);
        const unsigned gen = old / nloc;
        if (old + 1u == (gen + 1u) * nloc) {
            __builtin_amdgcn_fence(__ATOMIC_RELEASE, "agent");
            asm volatile("s_waitcnt vmcnt(0)" ::: "memory");
            const unsigned og = xb_add(&bar[XB_TOP], 1u);
            const unsigned tg = og / nx;
            if (og + 1u == (tg + 1u) * nx) xb_add(&bar[XB_TOPGEN], 1u);
            else XB_SPIN(xb_ld(&bar[XB_TOPGEN]) == tg, bar);
            __builtin_amdgcn_fence(__ATOMIC_ACQUIRE, "agent");
            xb_add(&bar[XB_XGEN(b.x)], 1u);
            asm volatile("s_waitcnt vmcnt(0)" ::: "memory");
        } else {
            XB_SPIN(xb_ld(&bar[XB_XGEN(b.x)]) == gen, bar);
            __builtin_amdgcn_fence(__ATOMIC_ACQUIRE, "agent");
            asm volatile("s_waitcnt vmcnt(0)" ::: "memory");
        }
    }
    __syncthreads();
}

struct Args {
    const float* in[14]; float* out; unsigned char* ws;
    float lg2[4];
    int ph_lo, ph_hi;
};

__device__ __forceinline__ float wave_sum(float v) {
#pragma unroll
    for (int o = 1; o < 64; o <<= 1) v += __shfl_xor(v, o);
    return v;
}

__device__ __forceinline__ void p0_transpose_item(const float* W, int N, bf16* WT, int LDK, int koff, int k0, int n0, int dest0, LAS float* scr, int lane) {
#pragma unroll 8
    for (int i = 0; i < 32; ++i) { const int kk = 2 * i + (lane >> 5); scr[kk * 33 + (lane & 31)] = W[(size_t)(k0 + kk) * N + n0 + (lane & 31)]; }
    asm volatile("s_waitcnt lgkmcnt(0)" ::: "memory");
    const int c = lane & 7;
#pragma unroll
    for (int j = 0; j < 4; ++j) { const int n = (lane >> 3) + 8 * j; const LAS float* s = scr + (8 * c) * 33 + n;
        v4u o; o.x = pk2(s[0 * 33], s[1 * 33]); o.y = pk2(s[2 * 33], s[3 * 33]); o.z = pk2(s[4 * 33], s[5 * 33]); o.w = pk2(s[6 * 33], s[7 * 33]);
        *(v4u*)(WT + (size_t)(dest0 + n) * LDK + koff + k0 + 8 * c) = o; }
    asm volatile("s_waitcnt lgkmcnt(0)" ::: "memory");
}
__device__ __forceinline__ int dest_up(int n0) { return (n0 < DFF) ? ((n0 >> 7) * 256 + (n0 & 127)) : (((n0 - DFF) >> 7) * 256 + 128 + ((n0 - DFF) & 127)); }
__device__ __forceinline__ int dest_win(int n0) {
    if (n0 < 1024) { const int sec = n0 >> 9, head = (n0 & 511) >> 7, d = n0 & 127; return (sec * 2 + (head >> 1)) * 256 + ((d >= 64) ? 128 : 0) + (head & 1) * 64 + (d & 63); }
    if (n0 >= 4096 && n0 < 6144) { const int sec = (n0 - 4096) >> 10, j = (n0 - 4096) & 1023; return 4096 + (j >> 7) * 256 + sec * 128 + (j & 127); }
    return n0;
}

__device__ __forceinline__ void rms_row_to_bf16(const float* xrow, const float* g, bf16* orow, int lane) {
    const f32x4* xr = (const f32x4*)xrow + lane; const f32x4* gr = (const f32x4*)g + lane;
    f32x4 v[4]; float s = 0.f;
#pragma unroll
    for (int j = 0; j < 4; ++j) { v[j] = xr[64 * j]; s += (v[j].x * v[j].x + v[j].y * v[j].y) + (v[j].z * v[j].z + v[j].w * v[j].w); }
    const float rstd = 1.0f / sqrtf(wave_sum(s) * (1.f / D) + EPS);
    unsigned long long* o8 = (unsigned long long*)orow + lane;
#pragma unroll
    for (int j = 0; j < 4; ++j) { const f32x4 gg = gr[64 * j]; o8[64 * j] = (unsigned long long)pk2(v[j].x * rstd * gg.x, v[j].y * rstd * gg.y) | ((unsigned long long)pk2(v[j].z * rstd * gg.z, v[j].w * rstd * gg.w) << 32); }
}

__device__ __forceinline__ void rownorm_row(const float* frow, const float* brow, float* orow, bf16* xnrow, const float* gpost, const float* gnext, float scale, int lane) {
    const f32x4* fr = (const f32x4*)frow + lane; const f32x4* br = (const f32x4*)brow + lane; const f32x4* gp = (const f32x4*)gpost + lane;
    f32x4 v[4], b[4]; float s = 0.f;
#pragma unroll
    for (int j = 0; j < 4; ++j) { v[j] = fr[64 * j]; b[j] = br[64 * j]; s += (v[j].x * v[j].x + v[j].y * v[j].y) + (v[j].z * v[j].z + v[j].w * v[j].w); }
    const float rstd = scale / sqrtf(wave_sum(s) * (1.f / D) + EPS);
    float s2 = 0.f;
#pragma unroll
    for (int j = 0; j < 4; ++j) { const f32x4 gg = gp[64 * j]; v[j] = b[j] + v[j] * rstd * gg; s2 += (v[j].x * v[j].x + v[j].y * v[j].y) + (v[j].z * v[j].z + v[j].w * v[j].w); }
    f32x4* o = (f32x4*)orow + lane;
#pragma unroll
    for (int j = 0; j < 4; ++j) o[64 * j] = v[j];
    if (xnrow) {
        const float rstd2 = 1.0f / sqrtf(wave_sum(s2) * (1.f / D) + EPS);
        const f32x4* gn = (const f32x4*)gnext + lane; unsigned long long* o8 = (unsigned long long*)xnrow + lane;
#pragma unroll
        for (int j = 0; j < 4; ++j) { const f32x4 gg = gn[64 * j]; o8[64 * j] = (unsigned long long)pk2(v[j].x * rstd2 * gg.x, v[j].y * rstd2 * gg.y) | ((unsigned long long)pk2(v[j].z * rstd2 * gg.z, v[j].w * rstd2 * gg.w) << 32); }
    }
}

namespace ret {
constexpr int LDQ = 136;
constexpr int QS = 0, KS = QS + 128 * LDQ * 2, KZT = KS + 128 * LDQ * 2, VT = KZT + 128 * LDQ * 2, ST = VT + 32 * LDQ * 2, END = ST + 32 * LDQ * 2;
static_assert(END <= RING_BYTES, "retention LDS");
}

__device__ __forceinline__ void ret_prompt_unit(LAS unsigned char* lds, int b, int h, int es, float lg2, const bf16* Qb, const bf16* Kb, const bf16* Vb,
                                                bf16* Oun, float* SS, float* rsp  ) {
    using namespace ret;
    int tid_ = threadIdx.x; asm volatile("" : "+v"(tid_));
    const int tid = tid_, lane = tid & 63, w = __builtin_amdgcn_readfirstlane(tid >> 6), lr = lane & 15, lq = lane >> 4;
    LAS bf16* Qs = (LAS bf16*)(lds + QS); LAS bf16* Ks = (LAS bf16*)(lds + KS); LAS bf16* KZt = (LAS bf16*)(lds + KZT);
    LAS bf16* Vt = (LAS bf16*)(lds + VT); LAS bf16* St = (LAS bf16*)(lds + ST);
    const int jj = tid & 127, dq = tid >> 7;
    const size_t rowb = (size_t)b * SEQ;
    const bf16* Qg = Qb + (rowb + jj) * 512 + h * 128 + dq * 32;
    const bf16* Kg = Kb + (rowb + jj) * 512 + h * 128 + dq * 32;
    const bf16* Vg = Vb + (rowb + jj) * 1024 + h * 256 + es * 32 + dq * 8;
    f32x4 accS[2]; accS[0] = (f32x4){0.f, 0.f, 0.f, 0.f}; accS[1] = accS[0];
    v4u q4[4], k4[4], vv;
#pragma unroll
    for (int x = 0; x < 4; ++x) { q4[x] = *(const v4u*)(Qg + 8 * x); k4[x] = *(const v4u*)(Kg + 8 * x); }
    vv = *(const v4u*)Vg;
    const float zeta = exp2f((float)(127 - jj) * lg2);
    const float gC = exp2f(128.0f * lg2);
    for (int c = 0; c < 16; ++c) {
        __syncthreads();
#pragma unroll
        for (int nb = 0; nb < 2; ++nb) { v2u s2; s2.x = pk2(accS[nb][0], accS[nb][1]); s2.y = pk2(accS[nb][2], accS[nb][3]);
            *(LAS v2u*)(St + (16 * nb + lr) * LDQ + 16 * w + 4 * lq) = s2; }
#pragma unroll
        for (int x = 0; x < 4; ++x) {
            *(LAS v4u*)(Qs + jj * LDQ + dq * 32 + 8 * x) = q4[x];
            *(LAS v4u*)(Ks + jj * LDQ + dq * 32 + 8 * x) = k4[x];
            const unsigned kw[4] = {k4[x].x, k4[x].y, k4[x].z, k4[x].w};
#pragma unroll
            for (int y = 0; y < 4; ++y) {
                KZt[(dq * 32 + 8 * x + 2 * y) * LDQ + jj] = (bf16)f2bf(bflo(kw[y]) * zeta);
                KZt[(dq * 32 + 8 * x + 2 * y + 1) * LDQ + jj] = (bf16)f2bf(bfhi(kw[y]) * zeta);
            }
        }
        { const unsigned vw[4] = {vv.x, vv.y, vv.z, vv.w};
#pragma unroll
          for (int y = 0; y < 4; ++y) { Vt[(dq * 8 + 2 * y) * LDQ + jj] = (bf16)(vw[y] & 0xffffu); Vt[(dq * 8 + 2 * y + 1) * LDQ + jj] = (bf16)(vw[y] >> 16); } }
        __syncthreads();
        if (c + 1 < 16) {
            const size_t adv = (size_t)(c + 1) * 128;
#pragma unroll
            for (int x = 0; x < 4; ++x) { q4[x] = *(const v4u*)(Qg + adv * 512 + 8 * x); k4[x] = *(const v4u*)(Kg + adv * 512 + 8 * x); }
            vv = *(const v4u*)(Vg + adv * 1024);
        }
        bf16x8 qf[4];
#pragma unroll
        for (int ks = 0; ks < 4; ++ks) qf[ks] = *(const LAS bf16x8*)(Qs + (16 * w + lr) * LDQ + 32 * ks + 8 * lq);
#pragma unroll
        for (int nb = 0; nb < 8; ++nb) {
            f32x4 a = (f32x4){0.f, 0.f, 0.f, 0.f};
            if (nb <= w) {
#pragma unroll
                for (int ks = 0; ks < 4; ++ks) { const bf16x8 kf = *(const LAS bf16x8*)(Ks + (16 * nb + lr) * LDQ + 32 * ks + 8 * lq);
                    a = __builtin_amdgcn_mfma_f32_16x16x32_bf16(qf[ks], kf, a, 0, 0, 0); }
            }
#pragma unroll
            for (int r = 0; r < 4; ++r) { const int i = 16 * w + 4 * lq + r, j = 16 * nb + lr, dl = i - j;
                const float p = (dl >= 0) ? a[r] * exp2f((float)dl * lg2) : 0.f;
                Qs[i * LDQ + j] = (bf16)f2bf(p); }
        }
        f32x4 ao[2], ac[2];
        ao[0] = (f32x4){0.f, 0.f, 0.f, 0.f}; ao[1] = ao[0]; ac[0] = ao[0]; ac[1] = ao[0];
        accS[0] = accS[0] * gC; accS[1] = accS[1] * gC;
#pragma unroll
        for (int ks = 0; ks < 4; ++ks) {
            const bf16x8 pf = *(const LAS bf16x8*)(Qs + (16 * w + lr) * LDQ + 32 * ks + 8 * lq);
            const bf16x8 kz = *(const LAS bf16x8*)(KZt + (16 * w + lr) * LDQ + 32 * ks + 8 * lq);
#pragma unroll
            for (int nb = 0; nb < 2; ++nb) {
                const bf16x8 vf = *(const LAS bf16x8*)(Vt + (16 * nb + lr) * LDQ + 32 * ks + 8 * lq);
                const bf16x8 sf = *(const LAS bf16x8*)(St + (16 * nb + lr) * LDQ + 32 * ks + 8 * lq);
                ao[nb] = __builtin_amdgcn_mfma_f32_16x16x32_bf16(pf, vf, ao[nb], 0, 0, 0);
                ac[nb] = __builtin_amdgcn_mfma_f32_16x16x32_bf16(qf[ks], sf, ac[nb], 0, 0, 0);
                accS[nb] = __builtin_amdgcn_mfma_f32_16x16x32_bf16(kz, vf, accS[nb], 0, 0, 0);
            }
        }
#pragma unroll
        for (int r = 0; r < 4; ++r) { const int i = 16 * w + 4 * lq + r; const float xi = exp2f((float)(i + 1) * lg2);
            const float o0 = ao[0][r] + xi * ac[0][r], o1 = ao[1][r] + xi * ac[1][r];
            float ss = o0 * o0 + o1 * o1;
            ss += __shfl_xor(ss, 1); ss += __shfl_xor(ss, 2); ss += __shfl_xor(ss, 4); ss += __shfl_xor(ss, 8);
            const size_t row = rowb + (size_t)c * 128 + i;
            bf16* op = Oun + row * 1024 + h * 256 + es * 32 + lr;
            op[0] = (bf16)f2bf(o0); op[16] = (bf16)f2bf(o1);
            if (lr == 0) SS[(row * 4 + h) * 8 + es] = ss; }
    }
#pragma unroll
    for (int nb = 0; nb < 2; ++nb)
#pragma unroll
        for (int r = 0; r < 4; ++r) rsp[(((size_t)b * 4 + h) * 128 + 16 * w + 4 * lq + r) * 256 + es * 32 + 16 * nb + lr] = accS[nb][r];
}

__device__ __forceinline__ void ret_sample_unit(LAS unsigned char* lds, int bs, int h, float lg2, const bf16* Qb, const bf16* Kb, const bf16* Vb,
                                                const float* S0  , float* Sout  , bf16* Oun, float* SS) {
    int tid_ = threadIdx.x; asm volatile("" : "+v"(tid_));
    const int tid = tid_, lane = tid & 63, w = __builtin_amdgcn_readfirstlane(tid >> 6);
    LAS float* qs = (LAS float*)lds;
    LAS float* ks = qs + 512;
    LAS float* sc = ks + 512;
    LAS float* red = sc + 64;
    const size_t row0 = (size_t)TP + (size_t)bs * 4;
    __syncthreads();
    { const int t = tid >> 7, d = tid & 127;
      qs[t * 128 + d] = bf2f(Qb[(row0 + t) * 512 + h * 128 + d]);
      ks[t * 128 + d] = bf2f(Kb[(row0 + t) * 512 + h * 128 + d]); }
    __syncthreads();
#pragma unroll
    for (int p = 0; p < 2; ++p) { const int pr = 2 * w + p, i = pr >> 2, j = pr & 3;
        float s = qs[i * 128 + lane] * ks[j * 128 + lane] + qs[i * 128 + 64 + lane] * ks[j * 128 + 64 + lane];
        s = wave_sum(s); if (lane == 0) sc[pr] = s; }
    f32x4 vj[4];
#pragma unroll
    for (int j = 0; j < 4; ++j) { const v2u t2 = *(const v2u*)(Vb + (row0 + j) * 1024 + h * 256 + 4 * lane); vj[j] = (f32x4){bflo(t2.x), bfhi(t2.x), bflo(t2.y), bfhi(t2.y)}; }
    const float g1 = exp2f(lg2), g2 = g1 * g1, g3 = g2 * g1, g4 = g2 * g2;
    const float zt[4] = {g3, g2, g1, 1.0f};
    f32x4 part[4];
#pragma unroll
    for (int i = 0; i < 4; ++i) part[i] = (f32x4){0.f, 0.f, 0.f, 0.f};
    f32x4 sv[16];
#pragma unroll
    for (int dd = 0; dd < 16; ++dd) sv[dd] = *(const f32x4*)(S0 + (size_t)(16 * w + dd) * 256 + 4 * lane);
#pragma unroll
    for (int dd = 0; dd < 16; ++dd) { const int d = 16 * w + dd;
        f32x4 sn = sv[dd] * g4;
#pragma unroll
        for (int j = 0; j < 4; ++j) sn = sn + vj[j] * (zt[j] * ks[j * 128 + d]);
        *(f32x4*)(Sout + (size_t)d * 256 + 4 * lane) = sn;
#pragma unroll
        for (int i = 0; i < 4; ++i) part[i] = part[i] + sv[dd] * qs[i * 128 + d]; }
#pragma unroll
    for (int i = 0; i < 4; ++i) *(LAS f32x4*)(red + (w * 4 + i) * 256 + 4 * lane) = part[i];
    __syncthreads();
    { const int i = tid >> 7, e0 = 2 * (tid & 127);
      float cr0 = 0.f, cr1 = 0.f;
#pragma unroll
      for (int ww = 0; ww < 8; ++ww) { cr0 += red[(ww * 4 + i) * 256 + e0]; cr1 += red[(ww * 4 + i) * 256 + e0 + 1]; }
      const float xi = exp2f((float)(i + 1) * lg2);
      float o0 = xi * cr0, o1 = xi * cr1;
      for (int j = 0; j <= i; ++j) { const float cf = sc[i * 4 + j] * exp2f((float)(i - j) * lg2);
          const unsigned t1 = *(const unsigned*)(Vb + (row0 + j) * 1024 + h * 256 + e0);
          o0 += cf * bflo(t1); o1 += cf * bfhi(t1); }
      *(unsigned*)(Oun + (row0 + i) * 1024 + h * 256 + e0) = pk2(o0, o1);
      float ss = wave_sum(o0 * o0 + o1 * o1);
      float* sp = SS + ((row0 + i) * 4 + h) * 8;
      if (lane == 0) sp[w & 1] = ss;
      if ((w & 1) == 0 && lane >= 2 && lane < 8) sp[lane] = 0.f; }
}

__device__ __forceinline__ void yprep_row(int row, int lane, const bf16* Oun, const float* SS, const bf16* SG, const bf16* BG, const bf16* Ab,
                                          const float* convw  , const float* sconv  , bf16* Y12) {
    const int c0 = 16 * lane;
    { const int hh = lane >> 4; const f32x4 s0 = *(const f32x4*)(SS + ((size_t)row * 4 + hh) * 8), s1 = *(const f32x4*)(SS + ((size_t)row * 4 + hh) * 8 + 4);
      const float rstd = 1.0f / sqrtf(((s0.x + s0.y) + (s0.z + s0.w) + (s1.x + s1.y) + (s1.z + s1.w)) * (1.f / HV) + EPS);
#pragma unroll
      for (int hv = 0; hv < 2; ++hv) { const v4u o4 = *(const v4u*)(Oun + (size_t)row * 1024 + c0 + 8 * hv), g4 = *(const v4u*)(SG + (size_t)row * 1024 + c0 + 8 * hv);
          v4u y; y.x = pk2(bflo(o4.x) * bflo(g4.x) * rstd, bfhi(o4.x) * bfhi(g4.x) * rstd); y.y = pk2(bflo(o4.y) * bflo(g4.y) * rstd, bfhi(o4.y) * bfhi(g4.y) * rstd);
          y.z = pk2(bflo(o4.z) * bflo(g4.z) * rstd, bfhi(o4.z) * bfhi(g4.z) * rstd); y.w = pk2(bflo(o4.w) * bflo(g4.w) * rstd, bfhi(o4.w) * bfhi(g4.w) * rstd);
          *(v4u*)(Y12 + (size_t)row * 2048 + c0 + 8 * hv) = y; } }
    { const int t = (row < TP) ? (row & 2047) : (row & 3); const bool smp = row >= TP; const int bs = (row - TP) >> 2;
#pragma unroll
      for (int hv = 0; hv < 2; ++hv) { const int cc = c0 + 8 * hv;
          float a0[8], a1[8], a2[8];
          { const v4u x = *(const v4u*)(Ab + (size_t)row * 1024 + cc); a2[0] = bflo(x.x); a2[1] = bfhi(x.x); a2[2] = bflo(x.y); a2[3] = bfhi(x.y); a2[4] = bflo(x.z); a2[5] = bfhi(x.z); a2[6] = bflo(x.w); a2[7] = bfhi(x.w); }
          if (t >= 1) { const v4u x = *(const v4u*)(Ab + (size_t)(row - 1) * 1024 + cc); a1[0] = bflo(x.x); a1[1] = bfhi(x.x); a1[2] = bflo(x.y); a1[3] = bfhi(x.y); a1[4] = bflo(x.z); a1[5] = bfhi(x.z); a1[6] = bflo(x.w); a1[7] = bfhi(x.w); }
          else if (smp) { const f32x4 p = *(const f32x4*)(sconv + ((size_t)bs * 2 + 1) * 1024 + cc), q = *(const f32x4*)(sconv + ((size_t)bs * 2 + 1) * 1024 + cc + 4); a1[0] = p.x; a1[1] = p.y; a1[2] = p.z; a1[3] = p.w; a1[4] = q.x; a1[5] = q.y; a1[6] = q.z; a1[7] = q.w; }
          else {
#pragma unroll
              for (int j = 0; j < 8; ++j) a1[j] = 0.f; }
          if (t >= 2) { const v4u x = *(const v4u*)(Ab + (size_t)(row - 2) * 1024 + cc); a0[0] = bflo(x.x); a0[1] = bfhi(x.x); a0[2] = bflo(x.y); a0[3] = bfhi(x.y); a0[4] = bflo(x.z); a0[5] = bfhi(x.z); a0[6] = bflo(x.w); a0[7] = bfhi(x.w); }
          else if (smp) { const f32x4 p = *(const f32x4*)(sconv + ((size_t)bs * 2 + t) * 1024 + cc), q = *(const f32x4*)(sconv + ((size_t)bs * 2 + t) * 1024 + cc + 4); a0[0] = p.x; a0[1] = p.y; a0[2] = p.z; a0[3] = p.w; a0[4] = q.x; a0[5] = q.y; a0[6] = q.z; a0[7] = q.w; }
          else {
#pragma unroll
              for (int j = 0; j < 8; ++j) a0[j] = 0.f; }
          const v4u b4 = *(const v4u*)(BG + (size_t)row * 1024 + cc);
          const float bgv[8] = {bflo(b4.x), bfhi(b4.x), bflo(b4.y), bfhi(b4.y), bflo(b4.z), bfhi(b4.z), bflo(b4.w), bfhi(b4.w)};
          float z[8];
#pragma unroll
          for (int q4i = 0; q4i < 2; ++q4i) { const f32x4 w0 = *(const f32x4*)(convw + cc + 4 * q4i), w1 = *(const f32x4*)(convw + 1024 + cc + 4 * q4i), w2 = *(const f32x4*)(convw + 2048 + cc + 4 * q4i);
#pragma unroll
              for (int j = 0; j < 4; ++j) z[4 * q4i + j] = bgv[4 * q4i + j] * (w0[j] * a0[4 * q4i + j] + w1[j] * a1[4 * q4i + j] + w2[j] * a2[4 * q4i + j]); }
          v4u y; y.x = pk2(z[0], z[1]); y.y = pk2(z[2], z[3]); y.z = pk2(z[4], z[5]); y.w = pk2(z[6], z[7]);
          *(v4u*)(Y12 + (size_t)row * 2048 + 1024 + cc) = y; } }
}

constexpr int NPHASE = 1 + 12 * DEPTH;
typedef const __attribute__((address_space(4))) Args* CArgs;
__device__ __forceinline__ CArgs largs() { CArgs p = (CArgs)__builtin_amdgcn_kernarg_segment_ptr(); asm volatile("" : "+s"(p)); return p; }

#if MK_PER_PHASE
#define IN(k) (largs()->ph_lo <= (k) && (k) < largs()->ph_hi)
#define GRID_BAR() do {} while (0)
#else
#define IN(k) true
#define GRID_BAR() do { XcdBarrier bar_; bar_.bar = (unsigned*)(largs()->ws + WS_CTL) + CW_BAR; bar_.x = xb_xcc_id(); bar_.st = (volatile LAS unsigned*)(lds + MISC_OFF) + 8; xcd_barrier(bar_); } while (0)
#endif
#define SEAM(k) do { if (IN(k) && IN((k) + 1)) GRID_BAR(); } while (0)

struct Tix { int tid, lane, wave, G, bx, gw, NGW; };
__device__ __forceinline__ Tix tix() { Tix t; t.tid = threadIdx.x; asm volatile("" : "+v"(t.tid)); t.lane = t.tid & 63; t.wave = __builtin_amdgcn_readfirstlane(t.tid >> 6); t.G = gridDim.x; t.bx = blockIdx.x;
    const int vcu = (t.G % 8 == 0) ? (t.bx % 8) * (t.G / 8) + t.bx / 8 : t.bx; t.gw = vcu * NWAVES + t.wave; t.NGW = t.G * NWAVES; return t; }

__device__ __forceinline__ void ph_prologue(LAS unsigned char* lds) {
    CArgs A = largs(); const Tix t = tix(); unsigned char* ws = A->ws;
    LAS float* scr = (LAS float*)(lds + RING_OFF + t.wave * 16384);
    constexpr int I_UP = 16 * 176, I_DN = 44 * 32, I_IN = 16 * 256, I_SQ = 16 * 32;
    constexpr int I_LAYER = 2 * I_UP + 2 * I_DN + I_IN + 3 * I_SQ;
    for (int it = t.gw; it < DEPTH * I_LAYER; it += t.NGW) {
        const int l = it / I_LAYER; int r = it - l * I_LAYER;
        char* WL = (char*)(ws + WS_W + (size_t)l * W_LAYER);
        const float* src; int N, LDK, koff = 0, nblk; size_t woff; int mode = 0;
        if (r < I_UP) { src = A->in[5] + (size_t)l * D * 2 * DFF; N = 2 * DFF; LDK = D; nblk = 176; woff = W_1U; mode = 1; }
        else if ((r -= I_UP) < I_DN) { src = A->in[6] + (size_t)l * DFF * D; N = D; LDK = DFF; nblk = 32; woff = W_1D; }
        else if ((r -= I_DN) < I_IN) { src = A->in[7] + (size_t)l * D * NIN; N = NIN; LDK = D; nblk = 256; woff = W_IN; mode = 2; }
        else if ((r -= I_IN) < I_SQ) { src = A->in[9] + (size_t)l * D * D; N = D; LDK = 2 * D; nblk = 32; woff = W_RC; }
        else if ((r -= I_SQ) < I_SQ) { src = A->in[10] + (size_t)l * D * D; N = D; LDK = 2 * D; koff = D; nblk = 32; woff = W_RC; }
        else if ((r -= I_SQ) < I_SQ) { src = A->in[11] + (size_t)l * D * D; N = D; LDK = D; nblk = 32; woff = W_O; }
        else if ((r -= I_SQ) < I_UP) { src = A->in[12] + (size_t)l * D * 2 * DFF; N = 2 * DFF; LDK = D; nblk = 176; woff = W_2U; mode = 1; }
        else { r -= I_UP; src = A->in[13] + (size_t)l * DFF * D; N = D; LDK = DFF; nblk = 32; woff = W_2D; }
        const int kb = r / nblk, nb = r % nblk, n0 = 32 * nb;
        const int dest0 = (mode == 1) ? dest_up(n0) : (mode == 2 ? dest_win(n0) : n0);
        p0_transpose_item(src, N, (bf16*)(WL + woff), LDK, koff, 64 * kb, n0, dest0, scr, t.lane);
    }
    const float* xp = A->in[0]; const float* xs = A->in[1]; const float* norms = A->in[4];
    bf16* XN = (bf16*)(ws + WS_XN);
    for (int m = t.gw; m < T; m += t.NGW) { const float* xr = (m < TP) ? xp + (size_t)m * D : xs + (size_t)(m - TP) * D; rms_row_to_bf16(xr, norms, XN + (size_t)m * D, t.lane); }
    float* COS = (float*)(ws + WS_TAB); float* SIN = (float*)(ws + WS_TAB + TAB_HALF);
    for (int i = t.bx * (NWAVES * 64) + t.tid; i < 2052 * 64; i += t.G * NWAVES * 64) { const int tp = i >> 6, dd = i & 63;
        const float pos = (float)((tp < 2048) ? tp : (16384 + tp - 2048));
        const float invf = powf(10000.0f, -((float)dd * 2.0f / 128.0f));
        const float ang = pos * invf; float sn, cs; sincosf(ang, &sn, &cs);
        COS[i] = cs; SIN[i] = sn; }
}

__device__ __forceinline__ void ph_ffn_up(LAS unsigned char* lds, int l, int f) {
    CArgs A = largs(); unsigned char* ws = A->ws;
    const unsigned char* WL = ws + WS_W + (size_t)l * W_LAYER;
    pg8::Gemm g{(const bf16*)(ws + WS_XN), (const bf16*)(WL + (f ? W_2U : W_1U)), T, 2 * DFF, D}; pg8::StaticOrder S; S.init(T, 2 * DFF, gridDim.x, blockIdx.x);
    pg8::EpiSwiGLU E{(bf16*)(ws + WS_R1), DFF};
    pg8::gemm_phase<pg8::EpiSwiGLU, pg8::StaticOrder, true, true>(lds + RING_OFF, g, S, E);
}
__device__ __forceinline__ void ph_ffn_down(LAS unsigned char* lds, int l, int f) {
    CArgs A = largs(); unsigned char* ws = A->ws;
    const unsigned char* WL = ws + WS_W + (size_t)l * W_LAYER;
    pg8::Gemm g{(const bf16*)(ws + WS_R1), (const bf16*)(WL + (f ? W_2D : W_1D)), T, D, DFF}; pg8::StaticOrder S; S.init(T, D, gridDim.x, blockIdx.x);
    pg8::EpiF32 E{(float*)(ws + WS_F), D};
    pg8::gemm_phase<pg8::EpiF32, pg8::StaticOrder, true, true>(lds + RING_OFF, g, S, E);
}
__device__ __forceinline__ void ph_rownorm(int l, int which) {
    CArgs A = largs(); const Tix t = tix(); unsigned char* ws = A->ws;
    const float* norms = A->in[4]; const float* nl = norms + (size_t)l * 6 * D;
    const float* xp = A->in[0]; const float* xs = A->in[1];
    float* H = A->out + OUT_Y; const float* F = (const float*)(ws + WS_F); bf16* XN = (bf16*)(ws + WS_XN);
    const float* gpost = nl + (which == 0 ? 1 : (which == 1 ? 3 : 5)) * D;
    const bool final_ = (which == 2 && l == DEPTH - 1);
    const float* gnext = (which == 0) ? nl + 2 * D : (which == 1 ? nl + 4 * D : (final_ ? nl : nl + 6 * D));
    const float scale = (which == 1) ? 1.0f : 0.5f;
    const bool from_x = (l == 0 && which == 0);
    for (int m = t.gw; m < T; m += t.NGW) {
        const float* brow = from_x ? ((m < TP) ? xp + (size_t)m * D : xs + (size_t)(m - TP) * D) : H + (size_t)m * D;
        rownorm_row(F + (size_t)m * D, brow, H + (size_t)m * D, final_ ? nullptr : XN + (size_t)m * D, gpost, gnext, scale, t.lane);
    }
}
__device__ __forceinline__ void ph_inproj(LAS unsigned char* lds, int l) {
    CArgs A = largs(); unsigned char* ws = A->ws;
    const unsigned char* WL = ws + WS_W + (size_t)l * W_LAYER;
    pg8::Gemm g{(const bf16*)(ws + WS_XN), (const bf16*)(WL + W_IN), T, NIN, D}; pg8::StaticOrder S; S.init(T, NIN, gridDim.x, blockIdx.x);
    pg8::EpiInProj E{(bf16*)(ws + WS_R1 + R1_Q), (bf16*)(ws + WS_R1 + R1_K), (bf16*)(ws + WS_R1 + R1_PB), (bf16*)(ws + WS_R1 + R1_A),
                     (const float*)(ws + WS_TAB), (const float*)(ws + WS_TAB + TAB_HALF),
                     A->out + OUT_CSP + (size_t)l * 8 * 2 * 1024, A->out + OUT_CSS + (size_t)l * 128 * 2 * 1024, PB_STRIDE_B / 2};
    pg8::gemm_phase<pg8::EpiInProj, pg8::StaticOrder, true, true>(lds + RING_OFF, g, S, E);
}
__device__ __forceinline__ void ph_retention(LAS unsigned char* lds, int l) {
    CArgs A = largs(); unsigned char* ws = A->ws; const int G = gridDim.x, bx = blockIdx.x;
    const bf16* Qb = (const bf16*)(ws + WS_R1 + R1_Q); const bf16* Kb = (const bf16*)(ws + WS_R1 + R1_K); const bf16* Vb = (const bf16*)(ws + WS_R1 + R1_PB);
    bf16* OUN = (bf16*)(ws + WS_XN); float* SS = (float*)(ws + WS_SS);
    for (int u = bx; u < 256; u += G) { const int b = u >> 5, h = (u >> 3) & 3, es = u & 7;
        ret_prompt_unit(lds, b, h, es, A->lg2[h], Qb, Kb, Vb, OUN, SS, A->out + OUT_RSP + (size_t)l * 8 * 4 * 128 * 256); }
    for (int u = bx; u < 512; u += G) { const int bs = u >> 2, h = u & 3;
        const size_t so = (((size_t)l * 128 + bs) * 4 + h) * 128 * 256;
        ret_sample_unit(lds, bs, h, A->lg2[h], Qb, Kb, Vb, A->in[2] + so, A->out + OUT_RSS + so, OUN, SS); }
}
__device__ __forceinline__ void ph_yprep(int l) {
    CArgs A = largs(); const Tix t = tix(); unsigned char* ws = A->ws;
    const bf16* PB = (const bf16*)(ws + WS_R1 + R1_PB); const size_t PBS = PB_STRIDE_B / 2;
    const float* cw = A->in[8] + (size_t)l * 3 * 1024; const float* scv = A->in[3] + (size_t)l * 128 * 2 * 1024;
    for (int m = t.gw; m < T; m += t.NGW)
        yprep_row(m, t.lane, (const bf16*)(ws + WS_XN), (const float*)(ws + WS_SS), PB + PBS, PB + 2 * PBS, (const bf16*)(ws + WS_R1 + R1_A), cw, scv, (bf16*)(ws + WS_F));
}
__device__ __forceinline__ void ph_merged(LAS unsigned char* lds, int l) {
    CArgs A = largs(); unsigned char* ws = A->ws;
    const unsigned char* WL = ws + WS_W + (size_t)l * W_LAYER; const size_t PBS = PB_STRIDE_B / 2;
    const bf16* PB = (const bf16*)(ws + WS_R1 + R1_PB);
    pg8::Gemm g{(const bf16*)(ws + WS_F), (const bf16*)(WL + W_RC), T, D, 2 * D}; pg8::StaticOrder S; S.init(T, D, gridDim.x, blockIdx.x);
    pg8::EpiMerged E{PB + 3 * PBS, PB + 4 * PBS, (bf16*)(ws + WS_R1)};
    pg8::gemm_phase<pg8::EpiMerged, pg8::StaticOrder, true, true>(lds + RING_OFF, g, S, E);
}
__device__ __forceinline__ void ph_wo(LAS unsigned char* lds, int l) {
    CArgs A = largs(); unsigned char* ws = A->ws;
    const unsigned char* WL = ws + WS_W + (size_t)l * W_LAYER;
    pg8::Gemm g{(const bf16*)(ws + WS_R1), (const bf16*)(WL + W_O), T, D, D}; pg8::StaticOrder S; S.init(T, D, gridDim.x, blockIdx.x);
    pg8::EpiF32 E{(float*)(ws + WS_F), D};
    pg8::gemm_phase<pg8::EpiF32, pg8::StaticOrder, true, true>(lds + RING_OFF, g, S, E);
}

__global__ void __launch_bounds__(NWAVES * 64, 2) mk_fwd(Args args) {
    extern __shared__ __attribute__((aligned(16))) unsigned char lds_raw[];
    LAS unsigned char* lds = (LAS unsigned char*)lds_raw;
    for (int u = threadIdx.x; u < (LDS_BYTES - LDSCTL_OFF) / 4; u += NWAVES * 64) ((LAS unsigned*)(lds + LDSCTL_OFF))[u] = 0u;
    __syncthreads();
#if !MK_PER_PHASE
    (void)xcd_barrier_post((unsigned*)(largs()->ws + WS_CTL) + CW_BAR, (volatile LAS unsigned*)(lds + MISC_OFF) + 8);
#endif
    if (IN(0)) ph_prologue(lds);
    SEAM(0);
#pragma unroll 1
    for (int l = 0; l < DEPTH; ++l) {
        const int pb = 1 + 12 * l;
#pragma unroll 1
        for (int f = 0; f < 2; ++f) {
            const int p_up = pb + (f ? 9 : 0);
            if (IN(p_up)) ph_ffn_up(lds, l, f);
            SEAM(p_up);
            if (IN(p_up + 1)) ph_ffn_down(lds, l, f);
            SEAM(p_up + 1);
            if (IN(p_up + 2)) ph_rownorm(l, f ? 2 : 0);
            if (!(f == 1 && l == DEPTH - 1)) SEAM(p_up + 2);
            if (f == 0) {
                if (IN(pb + 3)) ph_inproj(lds, l);
                SEAM(pb + 3);
                if (IN(pb + 4)) ph_retention(lds, l);
                SEAM(pb + 4);
                if (IN(pb + 5)) ph_yprep(l);
                SEAM(pb + 5);
                if (IN(pb + 6)) ph_merged(lds, l);
                SEAM(pb + 6);
                if (IN(pb + 7)) ph_wo(lds, l);
                SEAM(pb + 7);
                if (IN(pb + 8)) ph_rownorm(l, 1);
                SEAM(pb + 8);
            }
        }
    }
}

extern "C" void kernel_launch(void* const* d_in, const int* in_sizes, int n_in, void* d_out, int out_size, void* d_ws, size_t ws_size, hipStream_t stream) {
    static int grid = 0;
    if (grid == 0) {
        if (n_in != 14 || ws_size < WS_END) { fprintf(stderr, "kernel_launch: unexpected n_in %d or ws_size %zu (need %zu)\n", n_in, ws_size, (size_t)WS_END); grid = -1; return; }
        int dev = 0, cus = 0, per_cu = 0;
        if (hipGetDevice(&dev) != hipSuccess || hipDeviceGetAttribute(&cus, hipDeviceAttributeMultiprocessorCount, dev) != hipSuccess) { grid = -1; return; }
        if (hipFuncSetAttribute((const void*)mk_fwd, hipFuncAttributeMaxDynamicSharedMemorySize, LDS_BYTES) != hipSuccess) { fprintf(stderr, "kernel_launch: hipFuncSetAttribute failed\n"); grid = -1; return; }
        if (hipOccupancyMaxActiveBlocksPerMultiprocessor(&per_cu, (const void*)mk_fwd, NWAVES * 64, LDS_BYTES) != hipSuccess || per_cu < 1) { fprintf(stderr, "kernel_launch: occupancy query says %d\n", per_cu); (void)hipGetLastError(); grid = -1; return; }
        grid = cus;
    }
    if (grid < 0) return;
    (void)hipMemsetAsync((char*)d_ws + WS_CTL, 0, CTL_ZERO_BYTES, stream);
    Args a{};
    for (int i = 0; i < 14; ++i) a.in[i] = (const float*)d_in[i];
    a.out = (float*)d_out; a.ws = (unsigned char*)d_ws;
    for (int h = 0; h < 4; ++h) {
        const double lo = log(1.0 / 32.0), hi_ = log(1.0 / 512.0);
        const double v = lo + (hi_ - lo) * (double)h / 3.0;
        const double gam = 1.0 - exp(v);
        a.lg2[h] = (float)(log(gam) / log(2.0));
    }
#if MK_PER_PHASE
    for (int p = 0; p < NPHASE; ++p) { a.ph_lo = p; a.ph_hi = p + 1; hipLaunchKernelGGL(mk_fwd, dim3(grid), dim3(NWAVES * 64), LDS_BYTES, stream, a); }
#else
    a.ph_lo = 0; a.ph_hi = NPHASE;
    void* kargs[] = {&a};
    hipError_t e = hipLaunchCooperativeKernel((const void*)mk_fwd, dim3(grid), dim3(NWAVES * 64), kargs, LDS_BYTES, stream);
    if (e != hipSuccess) fprintf(stderr, "kernel_launch: cooperative launch failed: %s (grid %d)\n", hipGetErrorString(e), grid);
#endif
}
```
